# Optimizing an MI355X kernel written in HIP

```python
import jax
import jax.numpy as jnp
from jax import lax
import numpy as np

D_MODEL = 1024
BATCH = 16
SEQ = 2048
DEPTH = 4

MIX_WIDTH = D_MODEL
POOL_WIDTH = MIX_WIDTH // 2
POOL_WINDOWS = (2, 4, 8, 16)
N_POOL_GROUPS = len(POOL_WINDOWS)
POOL_CH = POOL_WIDTH // N_POOL_GROUPS
MAX_WINDOW = max(POOL_WINDOWS)
SB_WIDTH = MIX_WIDTH - POOL_WIDTH
SB_HEAD_DIM = 64
SB_HEADS = SB_WIDTH // SB_HEAD_DIM
Q_BLOCK = 128
PROJ_WIDTH = POOL_WIDTH + 3 * SB_WIDTH
N_EXPERT_GROUPS = 4
EXPERTS_PER_GROUP = 8
N_EXPERTS = N_EXPERT_GROUPS * EXPERTS_PER_GROUP
TOP_K = 2
D_EXPERT = D_MODEL // 2
DISPATCH_BLOCK = 128
DEEPNORM_ALPHA = (2.0 * DEPTH) ** 0.25
DEEPNORM_BETA = (8.0 * DEPTH) ** -0.25
LN_EPS = 1e-5

kernel_name = "hybrid_pool_stickbreak_hmoe"


def layer_norm(x, g, b):
    xf = x.astype(jnp.float32)
    mu = jnp.mean(xf, axis=-1, keepdims=True)
    xc = xf - mu
    var = jnp.mean(xc * xc, axis=-1, keepdims=True)
    y = xc * lax.rsqrt(var + LN_EPS) * g.astype(jnp.float32) + b.astype(jnp.float32)
    return y.astype(x.dtype)


def multiscale_pool(u, w_pool, pool_scale):
    B, S, _ = u.shape
    ug = u.reshape(B, S, N_POOL_GROUPS, POOL_CH).astype(jnp.float32)
    csum = jnp.cumsum(ug, axis=1)
    cpad = jnp.concatenate(
        [jnp.zeros((B, MAX_WINDOW, N_POOL_GROUPS, POOL_CH), jnp.float32), csum], axis=1)
    pos = jnp.arange(S, dtype=jnp.float32)
    sums, counts = [], []
    for g, w in enumerate(POOL_WINDOWS):
        lo = cpad[:, MAX_WINDOW - w:MAX_WINDOW - w + S, g]
        sums.append(csum[:, :, g] - lo)
        counts.append(jnp.minimum(pos + 1.0, float(w)))
    wsum = jnp.stack(sums, axis=2)
    count = jnp.stack(counts, axis=1)
    pooled = wsum / count[None, :, :, None] - ug
    mixed = jnp.einsum('bsgc,gcd->bsgd', pooled.astype(u.dtype), w_pool)
    return mixed.reshape(B, S, POOL_WIDTH) * pool_scale


def stick_breaking_attention(q, k, v):
    B, S, H, Dh = q.shape
    n_blocks = S // Q_BLOCK
    scale = Dh ** -0.5
    qb = q.reshape(B, n_blocks, Q_BLOCK, H, Dh).transpose(1, 0, 3, 2, 4)
    kh = k.transpose(0, 2, 1, 3)
    vh = v.transpose(0, 2, 1, 3)
    key_pos = jnp.arange(S)

    def block(args):
        qi, bi = args
        z = jnp.einsum('bhqd,bhkd->bhqk', qi, kh).astype(jnp.float32) * scale
        q_pos = bi * Q_BLOCK + jnp.arange(Q_BLOCK)
        mask = key_pos[None, :] < q_pos[:, None]
        log_fail = jnp.where(mask, jax.nn.log_sigmoid(-z), 0.0)
        after = lax.cumsum(log_fail, axis=3, reverse=True) - log_fail
        a = jnp.where(mask, jnp.exp(jax.nn.log_sigmoid(z) + after), 0.0)
        return jnp.einsum('bhqk,bhkd->bhqd', a.astype(vh.dtype), vh)

    o = lax.map(block, (qb, jnp.arange(n_blocks)))
    return o.transpose(1, 0, 3, 2, 4).reshape(B, S, H * Dh)


def hierarchical_moe(h, w_rg, b_rg, w_re, b_re, w_gate, w_up, w_down):
    B, S, D = h.shape
    T = B * S
    xt = h.reshape(T, D)
    tok_idx = jnp.arange(T)
    g_logits = (xt @ w_rg).astype(jnp.float32) + b_rg.astype(jnp.float32)
    g_prob = jax.nn.softmax(g_logits, axis=-1)
    g_idx = jnp.argmax(g_logits, axis=-1).astype(jnp.int32)
    g_p = g_prob[tok_idx, g_idx]
    e_logits = (xt @ w_re).astype(jnp.float32).reshape(T, N_EXPERT_GROUPS, EXPERTS_PER_GROUP)
    e_logits = e_logits + b_re.astype(jnp.float32)
    e_prob = jax.nn.softmax(e_logits[tok_idx, g_idx], axis=-1)
    top_p, top_i = lax.top_k(e_prob, TOP_K)
    top_p = top_p / jnp.sum(top_p, axis=-1, keepdims=True)
    gate = g_p[:, None] * top_p
    expert = g_idx[:, None] * EXPERTS_PER_GROUP + top_i.astype(jnp.int32)

    A = T * TOP_K
    flat_e = expert.reshape(A)
    flat_w = gate.reshape(A)
    flat_tok = jnp.arange(A, dtype=jnp.int32) // TOP_K
    order = jnp.argsort(flat_e)
    se, stok, sw = flat_e[order], flat_tok[order], flat_w[order]
    counts = jax.ops.segment_sum(jnp.ones((A,), jnp.int32), flat_e, num_segments=N_EXPERTS)
    start = jnp.cumsum(counts) - counts
    padded = ((counts + DISPATCH_BLOCK - 1) // DISPATCH_BLOCK) * DISPATCH_BLOCK
    pstart = jnp.cumsum(padded) - padded
    pend = pstart + padded
    dest = pstart[se] + (jnp.arange(A, dtype=jnp.int32) - start[se])
    n_blocks = -(-A // DISPATCH_BLOCK) + N_EXPERTS
    P = n_blocks * DISPATCH_BLOCK
    slot_tok = jnp.zeros((P,), jnp.int32).at[dest].set(stok)
    slot_w = jnp.zeros((P,), jnp.float32).at[dest].set(sw)
    block_start = jnp.arange(n_blocks, dtype=jnp.int32) * DISPATCH_BLOCK
    block_e = jnp.minimum(jnp.sum(block_start[:, None] >= pend[None, :], axis=1),
                          N_EXPERTS - 1).astype(jnp.int32)
    xs = xt[slot_tok].reshape(n_blocks, DISPATCH_BLOCK, D)

    def expert_block(args):
        xb, e = args
        hid = jax.nn.silu(xb @ w_gate[e]) * (xb @ w_up[e])
        return hid @ w_down[e]

    ys = lax.map(expert_block, (xs, block_e)).reshape(P, D)
    out = jnp.zeros((T, D), ys.dtype).at[slot_tok].add(ys * slot_w[:, None].astype(ys.dtype))
    return out.reshape(B, S, D).astype(h.dtype)


def setup_inputs(seed: int = 0) -> dict:
    key = jax.random.key(seed)
    ks = jax.random.split(key, 17)
    nrm = jax.random.normal
    f32 = jnp.float32
    col_scale = jnp.concatenate([
        jnp.full((POOL_WIDTH + 2 * SB_WIDTH,), D_MODEL ** -0.5, f32),
        jnp.full((SB_WIDTH,), D_MODEL ** -0.5 * DEEPNORM_BETA, f32)])
    return {
        "x": nrm(ks[0], (BATCH, SEQ, D_MODEL), f32),
        "w_in": nrm(ks[1], (DEPTH, D_MODEL, PROJ_WIDTH), f32) * col_scale,
        "w_pool": nrm(ks[2], (DEPTH, N_POOL_GROUPS, POOL_CH, POOL_CH), f32) * POOL_CH ** -0.5,
        "pool_scale": 1.0 + 0.1 * nrm(ks[3], (DEPTH, POOL_WIDTH), f32),
        "w_out": nrm(ks[4], (DEPTH, MIX_WIDTH, D_MODEL), f32) * (MIX_WIDTH ** -0.5 * DEEPNORM_BETA),
        "ln1_g": 1.0 + 0.01 * nrm(ks[5], (DEPTH, D_MODEL), f32),
        "ln1_b": 0.01 * nrm(ks[6], (DEPTH, D_MODEL), f32),
        "w_router_group": nrm(ks[7], (DEPTH, D_MODEL, N_EXPERT_GROUPS), f32) * D_MODEL ** -0.5,
        "b_router_group": 0.01 * nrm(ks[8], (DEPTH, N_EXPERT_GROUPS), f32),
        "w_router_expert": nrm(ks[9], (DEPTH, D_MODEL, N_EXPERTS), f32) * D_MODEL ** -0.5,
        "b_router_expert": 0.01 * nrm(ks[10], (DEPTH, N_EXPERT_GROUPS, EXPERTS_PER_GROUP), f32),
        "w_gate": nrm(ks[11], (DEPTH, N_EXPERTS, D_MODEL, D_EXPERT), f32) * D_MODEL ** -0.5,
        "w_up": nrm(ks[12], (DEPTH, N_EXPERTS, D_MODEL, D_EXPERT), f32) * D_MODEL ** -0.5,
        "w_down": nrm(ks[13], (DEPTH, N_EXPERTS, D_EXPERT, D_MODEL), f32) * (D_EXPERT ** -0.5 * DEEPNORM_BETA),
        "ln2_g": 1.0 + 0.01 * nrm(ks[14], (DEPTH, D_MODEL), f32),
        "ln2_b": 0.01 * nrm(ks[15], (DEPTH, D_MODEL), f32),
    }


def reference(x, w_in, w_pool, pool_scale, w_out, ln1_g, ln1_b, w_router_group, b_router_group,
              w_router_expert, b_router_expert, w_gate, w_up, w_down, ln2_g, ln2_b):
    B, S, _ = x.shape
    h = x
    for l in range(DEPTH):
        proj = h @ w_in[l]
        u_pool = proj[..., :POOL_WIDTH]
        q = proj[..., POOL_WIDTH:POOL_WIDTH + SB_WIDTH].reshape(B, S, SB_HEADS, SB_HEAD_DIM)
        k = proj[..., POOL_WIDTH + SB_WIDTH:POOL_WIDTH + 2 * SB_WIDTH].reshape(B, S, SB_HEADS, SB_HEAD_DIM)
        v = proj[..., POOL_WIDTH + 2 * SB_WIDTH:].reshape(B, S, SB_HEADS, SB_HEAD_DIM)
        y_pool = multiscale_pool(u_pool, w_pool[l], pool_scale[l])
        y_sb = stick_breaking_attention(q, k, v)
        mix = jnp.concatenate([y_pool.astype(h.dtype), y_sb.astype(h.dtype)], axis=-1) @ w_out[l]
        h = layer_norm(DEEPNORM_ALPHA * h + mix, ln1_g[l], ln1_b[l])
        moe = hierarchical_moe(h, w_router_group[l], b_router_group[l], w_router_expert[l],
                               b_router_expert[l], w_gate[l], w_up[l], w_down[l])
        h = layer_norm(DEEPNORM_ALPHA * h + moe, ln2_g[l], ln2_b[l])
    return h
```

```cpp
#include <hip/hip_runtime.h>
#include <cstdio>
#include <cstdint>

#define LAS __attribute__((address_space(3)))
#define GAS __attribute__((address_space(1)))
typedef unsigned short bf16_t;
typedef short bf16x8 __attribute__((ext_vector_type(8)));
typedef short s16x4 __attribute__((ext_vector_type(4)));
typedef float f32x2 __attribute__((ext_vector_type(2)));
typedef float f32x4 __attribute__((ext_vector_type(4)));
typedef float f32x16 __attribute__((ext_vector_type(16)));
typedef unsigned u32x2 __attribute__((ext_vector_type(2)));
typedef unsigned u32x4 __attribute__((ext_vector_type(4)));
typedef __bf16 bf16x2_t __attribute__((ext_vector_type(2)));

__device__ __forceinline__ unsigned cvtpk(float lo, float hi) { f32x2 v = {lo, hi}; bf16x2_t b = __builtin_convertvector(v, bf16x2_t); return __builtin_bit_cast(unsigned, b); }
__device__ __forceinline__ float bflo(unsigned w) { return __uint_as_float(w << 16); }
__device__ __forceinline__ float bfhi(unsigned w) { return __uint_as_float(w & 0xffff0000u); }

namespace pg8 {
constexpr int BM = 256, BK = 64, HALF = 128, HTB = HALF * BK * 2  , STAGE_BYTES = 8 * HTB, NXCD = 8, WGM = 8;

__host__ __device__ __forceinline__ int lds_byte(int r, int c) { const int st = (r >> 4) * 2 + (c >> 5), rr = r & 15, cc = c & 31, ob = rr * 64 + cc * 2; return st * 1024 + (ob ^ (((ob >> 9) & 1) << 5)); }
__host__ __device__ __forceinline__ void stage_rc(int b, int& R, int& C) { const int st = b / 1024, sb = b % 1024, swz = sb ^ (((sb >> 9) & 1) << 5); R = (st >> 1) * 16 + swz / 64; C = (st & 1) * 32 + (swz % 64) / 2; }
__host__ __device__ __forceinline__ int perm32(int rho) { const int n = rho >> 4, i = rho & 15; return 8 * (i >> 2) + 4 * n + (i & 3); }

struct Unit { int pm, pn; size_t aoff, boff; int aux; };
struct Gemm { const bf16_t* A; const bf16_t* Bt; int K; };

struct TileOrder {
    int nM, nN, nwg, G, c;
    __device__ void init(int nM_, int nN_, int G_, int c_) { nM = nM_; nN = nN_; nwg = nM * nN; G = G_; c = c_; }
    __device__ bool tile(int i, int& pm, int& pn) const {
        const long L = (long)i * G + c; if (L >= nwg) return false;
        int wgid = (int)L; { const int q = nwg / NXCD, r = nwg % NXCD, xcd = wgid % NXCD, off = wgid / NXCD; wgid = (xcd < r ? xcd * (q + 1) : r * (q + 1) + (xcd - r) * q) + off; }
        const int nig = WGM * nN, gid = wgid / nig, fm = gid * WGM, gsz = (nM - fm) < WGM ? (nM - fm) : WGM;
        pm = fm + ((wgid % nig) % gsz); pn = (wgid % nig) / gsz; return true;
    }
};
struct DenseOrder {
    TileOrder t; int K; int i0, i1;
    __device__ void init(int M, int N, int K_, int G, int c, int i0_ = 0, int i1_ = 1 << 30) { t.init(M / BM, N / BM, G, c); K = K_; i0 = i0_; i1 = i1_; }
    __device__ bool next(int i, Unit& u) const {
        if (i0 + i >= i1) return false;
        if (!t.tile(i0 + i, u.pm, u.pn)) return false;
        u.aoff = (size_t)u.pm * BM * K * 2; u.boff = (size_t)u.pn * BM * K * 2; u.aux = 0; return true;
    }
    __device__ __forceinline__ void a_ready(const Unit&) const {}
    __device__ __forceinline__ void done(const Unit&) const {}
};
struct GroupedOrder {
    TileOrder t; int K, Nw, cap; const LAS int* tstart;
    __device__ void init(int nTiles, int N, int K_, int G, int c, const LAS int* ts, int cap_) { t.init(nTiles, N / BM, G, c); K = K_; Nw = N; tstart = ts; cap = cap_; }
    __device__ bool next(int i, Unit& u) const {
        if (!t.tile(i, u.pm, u.pn)) return false;
        int e = 0;
#pragma unroll 1
        for (int j = 1; j < 32; ++j) e += (tstart[j] <= u.pm) ? 1 : 0;
        e = __builtin_amdgcn_readfirstlane(e);
        const int t0 = __builtin_amdgcn_readfirstlane(tstart[e]);
        u.aoff = (size_t)u.pm * BM * K * 2; u.boff = ((size_t)e * Nw + (size_t)u.pn * BM) * K * 2; u.aux = e * cap + (u.pm - t0) * BM; return true;
    }
    __device__ __forceinline__ void a_ready(const Unit&) const {}
    __device__ __forceinline__ void done(const Unit&) const {}
};

struct EpiF32 {
    static constexpr bool PERM = false, AFTER_DRAIN = false;
    float* C; int ldc;
    __device__ __forceinline__ void operator()(const f32x4 (&acc)[2][2][4][2], const Unit& u, int wr, int wc, int fr, int fq) const {
        const int row0 = u.pm * BM + wr * 64 + fr, col0 = u.pn * BM + wc * 32 + 4 * fq;
#pragma unroll
        for (int ai = 0; ai < 2; ++ai)
#pragma unroll
            for (int m = 0; m < 4; ++m) { float* rowp = C + (size_t)(row0 + ai * HALF + m * 16) * ldc + col0;
#pragma unroll
                for (int bj = 0; bj < 2; ++bj)
#pragma unroll
                    for (int n = 0; n < 2; ++n) *(f32x4*)(rowp + bj * HALF + n * 16) = acc[ai][bj][m][n]; }
    }
};
struct EpiBf16 {
    static constexpr bool PERM = true, AFTER_DRAIN = false;
    bf16_t* O; int ldc; int split_cols; size_t split_stride;
    __device__ __forceinline__ void operator()(const f32x4 (&acc)[2][2][4][2], const Unit& u, int wr, int wc, int fr, int fq) const {
        const int row0 = u.pm * BM + wr * 64 + fr; int colt = u.pn * BM; bf16_t* base = O;
        if (split_cols) { const int t = colt / split_cols; base += (size_t)t * split_stride; colt -= t * split_cols; }
        const int col0 = colt + wc * 32 + 8 * fq;
#pragma unroll
        for (int ai = 0; ai < 2; ++ai)
#pragma unroll
            for (int m = 0; m < 4; ++m) { bf16_t* rowp = base + (size_t)(row0 + ai * HALF + m * 16) * ldc + col0;
#pragma unroll
                for (int bj = 0; bj < 2; ++bj) { const f32x4 v0 = acc[ai][bj][m][0], v1 = acc[ai][bj][m][1];
                    u32x4 w; w.x = cvtpk(v0[0], v0[1]); w.y = cvtpk(v0[2], v0[3]); w.z = cvtpk(v1[0], v1[1]); w.w = cvtpk(v1[2], v1[3]);
                    *(u32x4*)(rowp + bj * HALF) = w; } }
    }
};
struct EpiSwiGLU {
    static constexpr bool PERM = true, AFTER_DRAIN = false;
    bf16_t* O; int ldc;
    __device__ __forceinline__ void operator()(const f32x4 (&acc)[2][2][4][2], const Unit& u, int wr, int wc, int fr, int fq) const {
        const int row0 = u.pm * BM + wr * 64 + fr, col0 = u.pn * HALF + wc * 32 + 8 * fq;
#pragma unroll
        for (int ai = 0; ai < 2; ++ai)
#pragma unroll
            for (int m = 0; m < 4; ++m) { bf16_t* rowp = O + (size_t)(row0 + ai * HALF + m * 16) * ldc + col0;
                float h[8];
#pragma unroll
                for (int n = 0; n < 2; ++n)
#pragma unroll
                    for (int j = 0; j < 4; ++j) { const float g = acc[ai][0][m][n][j], up = acc[ai][1][m][n][j];
                        const float sg = g * __builtin_amdgcn_rcpf(1.0f + __builtin_amdgcn_exp2f(-1.4426950408889634f * g)); h[n * 4 + j] = sg * up; }
                u32x4 w; w.x = cvtpk(h[0], h[1]); w.y = cvtpk(h[2], h[3]); w.z = cvtpk(h[4], h[5]); w.w = cvtpk(h[6], h[7]);
                *(u32x4*)rowp = w; }
    }
};
struct EpiRowScaleBf16 {
    static constexpr bool PERM = true, AFTER_DRAIN = false;
    bf16_t* O; int ldc; const float* roww;
    __device__ __forceinline__ void operator()(const f32x4 (&acc)[2][2][4][2], const Unit& u, int wr, int wc, int fr, int fq) const {
        const int rt = wr * 64 + fr, row0 = u.pm * BM + rt, col0 = u.pn * BM + wc * 32 + 8 * fq;
#pragma unroll
        for (int ai = 0; ai < 2; ++ai)
#pragma unroll
            for (int m = 0; m < 4; ++m) { bf16_t* rowp = O + (size_t)(row0 + ai * HALF + m * 16) * ldc + col0;
                const float s = roww[u.aux + rt + ai * HALF + m * 16];
#pragma unroll
                for (int bj = 0; bj < 2; ++bj) { const f32x4 v0 = acc[ai][bj][m][0] * s, v1 = acc[ai][bj][m][1] * s;
                    u32x4 w; w.x = cvtpk(v0[0], v0[1]); w.y = cvtpk(v0[2], v0[3]); w.z = cvtpk(v1[0], v1[1]); w.w = cvtpk(v1[2], v1[3]);
                    *(u32x4*)(rowp + bj * HALF) = w; } }
    }
};
template <class Epi, class Sched, bool ALIGN_EPI = false, bool SP2 = false>
__device__ __forceinline__ void gemm_phase(LAS unsigned char* lds, const Gemm g, const Sched& S, const Epi& E, const int tid) {
    const int wid = __builtin_amdgcn_readfirstlane(tid >> 6), lane = tid & 63, wr = wid >> 2, wc = wid & 3, fr = lane & 15, fq = lane >> 4;
    const int K = g.K, nt = K / BK;
    unsigned voffA[2], voffB[2];
#pragma unroll
    for (int i = 0; i < 2; ++i) { int R, C; stage_rc(tid * 16 + i * 8192, R, C); const int Rb = Epi::PERM ? ((R & ~31) + perm32(R & 31)) : R;
        voffA[i] = (unsigned)(R * K + C) * 2u; voffB[i] = (unsigned)(Rb * K + C) * 2u; }
    const size_t kstep = (size_t)(BK * 2);
    const size_t hstep = (size_t)HALF * K * 2;
    const unsigned ldsw = (unsigned)wid * 1024u;
    const int aoff = lds_byte(wr * 64 + fr, fq * 8), boff = lds_byte(wc * 32 + fr, fq * 8);
#define PG8_SA(b, h) (((b) * 2 + (h)) * HTB)
#define PG8_SB(b, h) ((4 + (b) * 2 + (h)) * HTB)
#define PG8_STAGE(bufoff, gbase, voff) do { _Pragma("unroll") for (int _i = 0; _i < 2; ++_i) \
        __builtin_amdgcn_global_load_lds((const unsigned*)((const char*)(gbase) + (voff)[_i]), (LAS unsigned*)(lds + (bufoff) + ldsw + _i * 8192), 16, 0, 0); } while (0)
#define PG8_LDA(dst, b, h) do { _Pragma("unroll") for (int m = 0; m < 4; ++m) _Pragma("unroll") for (int k = 0; k < 2; ++k) dst[m][k] = *(const LAS bf16x8*)(lds + PG8_SA(b, h) + aoff + m * 2048 + k * 1024); } while (0)
#define PG8_LDB(dst, b, h) do { _Pragma("unroll") for (int n = 0; n < 2; ++n) _Pragma("unroll") for (int k = 0; k < 2; ++k) dst[n][k] = *(const LAS bf16x8*)(lds + PG8_SB(b, h) + boff + n * 2048 + k * 1024); } while (0)
#define PG8_MMA(ai, bj, At, Bt) do { __builtin_amdgcn_s_setprio(1); _Pragma("unroll") for (int m = 0; m < 4; ++m) _Pragma("unroll") for (int n = 0; n < 2; ++n) _Pragma("unroll") for (int k = 0; k < 2; ++k) \
        acc[ai][bj][m][n] = __builtin_amdgcn_mfma_f32_16x16x32_bf16(Bt[n][k], At[m][k], acc[ai][bj][m][n], 0, 0, 0); __builtin_amdgcn_s_setprio(0); } while (0)
#define PG8_WAIT_V(n) asm volatile("s_waitcnt vmcnt(" #n ")" ::: "memory")
#define PG8_WAIT_L(n) asm volatile("s_waitcnt lgkmcnt(" #n ")" ::: "memory")
#define PG8_BAR __builtin_amdgcn_s_barrier()
#define PG8_SCHED __builtin_amdgcn_sched_barrier(0)
    Unit cur, nxt; int ui = 0;
    if (!S.next(0, cur)) return;
    f32x4 acc[2][2][4][2];
#pragma unroll
    for (int a = 0; a < 2; ++a)
#pragma unroll
        for (int b = 0; b < 2; ++b)
#pragma unroll
            for (int m = 0; m < 4; ++m)
#pragma unroll
                for (int n = 0; n < 2; ++n) acc[a][b][m][n] = (f32x4){0.f, 0.f, 0.f, 0.f};
    bf16x8 At[4][2], B0[2][2], B1[2][2];
    const char* cA = (const char*)g.A + cur.aoff; const char* cB = (const char*)g.Bt + cur.boff;
    S.a_ready(cur);
    if constexpr (SP2) {
        PG8_STAGE(PG8_SB(0, 0), cB, voffB); PG8_STAGE(PG8_SB(0, 1), cB + hstep, voffB); PG8_STAGE(PG8_SA(0, 0), cA, voffA); PG8_STAGE(PG8_SA(0, 1), cA + hstep, voffA);
        if (wr == 1) PG8_BAR;
        PG8_WAIT_V(2); PG8_BAR;
        PG8_STAGE(PG8_SB(1, 0), cB + kstep, voffB); PG8_STAGE(PG8_SA(1, 0), cA + kstep, voffA); PG8_STAGE(PG8_SB(1, 1), cB + hstep + kstep, voffB);
        PG8_WAIT_V(6); PG8_BAR;
    } else {
        PG8_STAGE(PG8_SB(0, 0), cB, voffB); PG8_STAGE(PG8_SA(0, 0), cA, voffA); PG8_STAGE(PG8_SB(0, 1), cB + hstep, voffB); PG8_STAGE(PG8_SA(0, 1), cA + hstep, voffA);
        if (wr == 1) PG8_BAR;
        PG8_WAIT_V(4); PG8_BAR;
        PG8_STAGE(PG8_SB(1, 0), cB + kstep, voffB); PG8_STAGE(PG8_SA(1, 0), cA + kstep, voffA); PG8_STAGE(PG8_SB(1, 1), cB + hstep + kstep, voffB);
        PG8_WAIT_V(6); PG8_BAR;
    }
    for (;;) {
        const bool has_next = S.next(ui + 1, nxt);
        const char* nA = has_next ? (const char*)g.A + nxt.aoff : cA; const char* nB = has_next ? (const char*)g.Bt + nxt.boff : cB;
        for (int t = 0; t < nt; t += 2) {
            const bool last = (t == nt - 2);
            const char* a1 = cA + (size_t)(t + 1) * kstep;
            const char* a2 = last ? nA : cA + (size_t)(t + 2) * kstep; const char* b2 = last ? nB : cB + (size_t)(t + 2) * kstep;
            const char* a3 = a2 + kstep; const char* b3 = b2 + kstep;
            if (last && has_next) S.a_ready(nxt);
            if constexpr (SP2) {
            PG8_LDB(B0, 0, 0); PG8_LDB(B1, 0, 1); PG8_SCHED; PG8_LDA(At, 0, 0); PG8_STAGE(PG8_SA(1, 1), a1 + hstep, voffA);
            PG8_WAIT_V(8); PG8_WAIT_L(0); PG8_BAR; PG8_MMA(0, 0, At, B0); PG8_MMA(0, 1, At, B1); PG8_BAR; PG8_SCHED;
            PG8_LDA(At, 0, 1); PG8_STAGE(PG8_SB(0, 0), b2, voffB); PG8_STAGE(PG8_SB(0, 1), b2 + hstep, voffB); PG8_STAGE(PG8_SA(0, 0), a2, voffA);
            PG8_WAIT_V(8); PG8_WAIT_L(0); PG8_BAR; PG8_MMA(1, 0, At, B0); PG8_MMA(1, 1, At, B1); PG8_BAR; PG8_SCHED;
            PG8_LDB(B0, 1, 0); PG8_LDB(B1, 1, 1); PG8_SCHED; PG8_LDA(At, 1, 0); PG8_STAGE(PG8_SA(0, 1), a2 + hstep, voffA);
            PG8_WAIT_V(8); PG8_WAIT_L(0); PG8_BAR; PG8_MMA(0, 0, At, B0); PG8_MMA(0, 1, At, B1); PG8_BAR; PG8_SCHED;
            PG8_LDA(At, 1, 1); PG8_STAGE(PG8_SB(1, 0), b3, voffB); PG8_STAGE(PG8_SB(1, 1), b3 + hstep, voffB); PG8_STAGE(PG8_SA(1, 0), a3, voffA);
            PG8_WAIT_V(8); PG8_WAIT_L(0); PG8_BAR; PG8_MMA(1, 0, At, B0); PG8_MMA(1, 1, At, B1); PG8_BAR; PG8_SCHED;
            } else {
            PG8_LDB(B0, 0, 0); PG8_SCHED; PG8_LDA(At, 0, 0); PG8_STAGE(PG8_SA(1, 1), a1 + hstep, voffA);
            PG8_WAIT_L(8); PG8_BAR; PG8_WAIT_L(0); PG8_MMA(0, 0, At, B0); PG8_BAR; PG8_SCHED;
            PG8_LDB(B1, 0, 1); PG8_STAGE(PG8_SB(0, 0), b2, voffB);
            PG8_BAR; PG8_WAIT_L(0); PG8_MMA(0, 1, At, B1); PG8_BAR;
            PG8_LDA(At, 0, 1); PG8_STAGE(PG8_SA(0, 0), a2, voffA);
            PG8_BAR; PG8_WAIT_L(0); PG8_MMA(1, 0, At, B0); PG8_BAR; PG8_SCHED;
            PG8_STAGE(PG8_SB(0, 1), b2 + hstep, voffB);
            PG8_WAIT_V(6); PG8_BAR; PG8_MMA(1, 1, At, B1); PG8_BAR;
            PG8_LDB(B0, 1, 0); PG8_SCHED; PG8_LDA(At, 1, 0); PG8_STAGE(PG8_SA(0, 1), a2 + hstep, voffA);
            PG8_WAIT_L(8); PG8_BAR; PG8_WAIT_L(0); PG8_MMA(0, 0, At, B0); PG8_BAR; PG8_SCHED;
            PG8_LDB(B1, 1, 1); PG8_STAGE(PG8_SB(1, 0), b3, voffB);
            PG8_BAR; PG8_WAIT_L(0); PG8_MMA(0, 1, At, B1); PG8_BAR;
            PG8_LDA(At, 1, 1); PG8_STAGE(PG8_SA(1, 0), a3, voffA);
            PG8_BAR; PG8_WAIT_L(0); PG8_MMA(1, 0, At, B0); PG8_BAR; PG8_SCHED;
            PG8_STAGE(PG8_SB(1, 1), b3 + hstep, voffB);
            PG8_WAIT_V(6); PG8_BAR; PG8_MMA(1, 1, At, B1); PG8_BAR;
            }
        }
        if constexpr (ALIGN_EPI) { if (wr == 0) PG8_BAR; }
        if constexpr (!Epi::AFTER_DRAIN) { E(acc, cur, wr, wc, fr, fq); S.done(cur); }
        if (!has_next) break;
#pragma unroll
        for (int a = 0; a < 2; ++a)
#pragma unroll
            for (int b = 0; b < 2; ++b)
#pragma unroll
                for (int m = 0; m < 4; ++m)
#pragma unroll
                    for (int n = 0; n < 2; ++n) acc[a][b][m][n] = (f32x4){0.f, 0.f, 0.f, 0.f};
        cur = nxt; cA = nA; cB = nB; ++ui;
        if constexpr (ALIGN_EPI) { if (wr == 1) PG8_BAR; }
    }
    PG8_WAIT_V(0);
    if constexpr (!ALIGN_EPI) { if (wr == 0) PG8_BAR; }
    PG8_BAR;
    if constexpr (Epi::AFTER_DRAIN) { E.fused(acc, cur, wr, wc, fr, fq, lds, wid, lane); S.done(cur); }
#undef PG8_SA
#undef PG8_SB
#undef PG8_STAGE
#undef PG8_LDA
#undef PG8_LDB
#undef PG8_MMA
#undef PG8_WAIT_V
#undef PG8_WAIT_L
#undef PG8_BAR
#undef PG8_SCHED
}
}

constexpr int NB = 16, SEQ = 2048, DM = 1024, T = NB * SEQ, DEPTH = 4;
constexpr int PW = 512, NPG = 4, PCH = 128, SBW = 512, NH = 8, HD = 64, PROJ = 2048;
constexpr int NE = 32, EPG = 8, NG = 4, DE = 512, NLOG = NG + NE;
constexpr int CAP = 65536;
constexpr float ALPHA = 1.6817928305074290f;
constexpr float LN_EPS = 1e-5f;
constexpr float C2 = 0.125f * 1.4426950408889634f;
constexpr int NWAVES = 8;

constexpr size_t MiB = 1u << 20;
constexpr size_t WS_CTL = 0, CTL_ZERO_BYTES = 1 * MiB;
constexpr size_t WS_WIN = 2 * MiB, WS_WO = 6 * MiB, WS_WGU = 8 * MiB, WS_WD = 72 * MiB, WS_WR = 104 * MiB;
constexpr size_t WS_HB = 106 * MiB, WS_PROJ = 170 * MiB, WS_MIXIN = 298 * MiB, WS_MIX = 362 * MiB;
constexpr size_t WS_TOKE = 490 * MiB, WS_TOKW = WS_TOKE + 256 * 1024, WS_TOKP = WS_TOKW + 256 * 1024;
constexpr size_t WS_SLOTT = 491 * MiB, WS_SLOTW = 499 * MiB;
constexpr size_t WS_XS = 508 * MiB, WS_HID = 652 * MiB, WS_Y = 724 * MiB, WS_END = 868 * MiB;
constexpr int CW_TMO = 0, CW_BAR = 4096, CW_CNT = 8192, CW_CUR = 8192 + 256;

constexpr int RING_OFF = 0, RING_BYTES = 131072;
constexpr int TBL_OFF = 143360;
constexpr int MISC_OFF = TBL_OFF + 512;
constexpr int LDS_BYTES = 147456;

struct Args { const float* in[16]; float* out; unsigned char* ws; int ph_lo, ph_hi; };
struct Frame {
    LAS unsigned char* lds;
    unsigned char* ws;
    int tid, lane, wave, G;
};
#define F_CTL(F)    ((unsigned*)((F).ws + WS_CTL))
#define F_WIN(F)    ((bf16_t*)((F).ws + WS_WIN))
#define F_WO(F)     ((bf16_t*)((F).ws + WS_WO))
#define F_WGU(F)    ((bf16_t*)((F).ws + WS_WGU))
#define F_WD(F)     ((bf16_t*)((F).ws + WS_WD))
#define F_WRT(F)    ((float*)((F).ws + WS_WR))
#define F_HB(F)     ((bf16_t*)((F).ws + WS_HB))
#define F_PU(F)     ((bf16_t*)((F).ws + WS_PROJ))
#define F_PQ(F)     ((bf16_t*)((F).ws + WS_PROJ) + (size_t)T * 512)
#define F_PK(F)     ((bf16_t*)((F).ws + WS_PROJ) + (size_t)T * 1024)
#define F_PV(F)     ((bf16_t*)((F).ws + WS_PROJ) + (size_t)T * 1536)
#define F_MIXIN(F)  ((bf16_t*)((F).ws + WS_MIXIN))
#define F_MIX(F)    ((float*)((F).ws + WS_MIX))
#define F_XS(F)     ((bf16_t*)((F).ws + WS_XS))
#define F_HID(F)    ((bf16_t*)((F).ws + WS_HID))
#define F_Y(F)      ((bf16_t*)((F).ws + WS_Y))
#define F_TOKE(F)   ((int*)((F).ws + WS_TOKE))
#define F_TOKP(F)   ((int*)((F).ws + WS_TOKP))
#define F_SLOTT(F)  ((int*)((F).ws + WS_SLOTT))
#define F_SLOTW(F)  ((float*)((F).ws + WS_SLOTW))

__device__ __forceinline__ float wave_sum(float v) {
#pragma unroll
    for (int o = 1; o < 64; o <<= 1) v += __shfl_xor(v, o);
    return v;
}

__device__ __forceinline__ void transpose_block(const float* src, int ld_s, bf16_t* dst, int ld_d, float scale, LAS float* scr, int lane) {
    const int c4 = (lane & 15) * 4, kr = lane >> 4;
    f32x4 v[16];
#pragma unroll
    for (int i = 0; i < 16; ++i) v[i] = *(const f32x4*)(src + (size_t)(4 * i + kr) * ld_s + c4);
#pragma unroll
    for (int i = 0; i < 16; ++i) { LAS float* s = scr + (4 * i + kr) * 65 + c4; s[0] = v[i].x; s[1] = v[i].y; s[2] = v[i].z; s[3] = v[i].w; }
    asm volatile("s_waitcnt lgkmcnt(0)" ::: "memory");
    const int c = lane & 7;
#pragma unroll
    for (int j = 0; j < 8; ++j) { const int n = (lane >> 3) + 8 * j; const LAS float* s = scr + (8 * c) * 65 + n;
        u32x4 o; o.x = cvtpk(s[0 * 65] * scale, s[1 * 65] * scale); o.y = cvtpk(s[2 * 65] * scale, s[3 * 65] * scale);
        o.z = cvtpk(s[4 * 65] * scale, s[5 * 65] * scale); o.w = cvtpk(s[6 * 65] * scale, s[7 * 65] * scale);
        *(u32x4*)(dst + (size_t)n * ld_d + 8 * c) = o; }
    asm volatile("s_waitcnt lgkmcnt(0)" ::: "memory");
}

__device__ __forceinline__ void ph_conv(const Frame& F, const Args& A, int l) {
    LAS float* scr = (LAS float*)(F.lds + RING_OFF) + F.wave * (64 * 65);
    const int lane = F.lane;
    const int gw = blockIdx.x * NWAVES + F.wave, NGW = F.G * NWAVES;
    const float* w_in = A.in[1] + (size_t)l * DM * PROJ;
    const float* w_pool = A.in[2] + (size_t)l * NPG * PCH * PCH;
    const float* pscale = A.in[3] + (size_t)l * PW;
    const float* w_out = A.in[4] + (size_t)l * DM * DM;
    const float* w_gate = A.in[11] + (size_t)l * NE * DM * DE;
    const float* w_up = A.in[12] + (size_t)l * NE * DM * DE;
    const float* w_down = A.in[13] + (size_t)l * NE * DE * DM;
    constexpr int I_IN = 16 * 24, I_O = 16 * 16, I_GU1 = 16 * 8, I_GU = NE * 2 * I_GU1, I_D1 = 8 * 16, I_D = NE * I_D1;
    constexpr int NITEMS = I_IN + I_O + I_GU + I_D;
    for (int it = gw; it < NITEMS; it += NGW) {
        int r = it;
        if (r < I_IN) { const int kb = r / 24, nb = r % 24, n0 = 512 + 64 * nb;
            transpose_block(w_in + (size_t)(64 * kb) * PROJ + n0, PROJ, F_WIN(F) + (size_t)n0 * DM + 64 * kb, DM, n0 < 1024 ? C2 : 1.0f, scr, lane); continue; }
        r -= I_IN;
        if (r < I_O) { const int kb = r / 16, nb = r % 16;
            transpose_block(w_out + (size_t)(64 * kb) * DM + 64 * nb, DM, F_WO(F) + (size_t)(64 * nb) * DM + 64 * kb, DM, 1.0f, scr, lane); continue; }
        r -= I_O;
        if (r < I_GU) { const int e = r / (2 * I_GU1), r2 = r % (2 * I_GU1), bj = r2 / I_GU1, r3 = r2 % I_GU1, kb = r3 / 8, nb = r3 % 8, n0 = 64 * nb;
            const float* src = (bj ? w_up : w_gate) + (size_t)e * DM * DE + (size_t)(64 * kb) * DE + n0;
            const int drow = 256 * (n0 >> 7) + 128 * bj + (n0 & 127);
            transpose_block(src, DE, F_WGU(F) + ((size_t)e * 1024 + drow) * DM + 64 * kb, DM, 1.0f, scr, lane); continue; }
        r -= I_GU;
        { const int e = r / I_D1, r3 = r % I_D1, kb = r3 / 16, nb = r3 % 16;
            transpose_block(w_down + (size_t)e * DE * DM + (size_t)(64 * kb) * DM + 64 * nb, DM, F_WD(F) + ((size_t)e * 1024 + 64 * nb) * DE + 64 * kb, DE, 1.0f, scr, lane); }
    }
    for (int it = gw; it < 256 * 8; it += NGW) {
        const int k0 = (it >> 3) * 4, g = (it >> 1) & 3, d = (it & 1) * 64 + lane;
        float a0 = 0.f, a1 = 0.f, a2 = 0.f, a3 = 0.f;
        const float* wp = w_pool + (size_t)g * PCH * PCH + d;
        const float* wi = w_in + (size_t)k0 * PROJ + 128 * g;
#pragma unroll 4
        for (int c = 0; c < PCH; ++c) { const float p = wp[(size_t)c * PCH];
            a0 += wi[c] * p; a1 += wi[PROJ + c] * p; a2 += wi[2 * PROJ + c] * p; a3 += wi[3 * PROJ + c] * p; }
        const float sc = pscale[128 * g + d];
        u32x2 o; o.x = cvtpk(a0 * sc, a1 * sc); o.y = cvtpk(a2 * sc, a3 * sc);
        *(u32x2*)(F_WIN(F) + (size_t)(128 * g + d) * DM + k0) = o;
    }
    { const float* wrg = A.in[7] + (size_t)l * DM * NG; const float* wre = A.in[9] + (size_t)l * DM * NE;
      for (int i = blockIdx.x * 512 + F.tid; i < NLOG * DM; i += F.G * 512) { const int n = i / DM, k = i % DM;
          F_WRT(F)[i] = n < NG ? wrg[k * NG + n] : wre[k * NE + (n - NG)]; } }
    if (l == 0) {
        const f32x4* x4 = (const f32x4*)A.in[0]; u32x2* h2 = (u32x2*)F_HB(F);
        for (size_t i = (size_t)blockIdx.x * 512 + F.tid; i < (size_t)T * DM / 4; i += (size_t)F.G * 512) { const f32x4 v = x4[i]; u32x2 o; o.x = cvtpk(v.x, v.y); o.y = cvtpk(v.z, v.w); h2[i] = o; }
    }
}

__device__ __forceinline__ f32x16 mfma32(bf16x8 a, bf16x8 b, f32x16 c) { return __builtin_amdgcn_mfma_f32_32x32x16_bf16(a, b, c, 0, 0, 0); }
typedef short v4i16_t __attribute__((ext_vector_type(4)));
__device__ __forceinline__ s16x4 vtr(const LAS unsigned char* p) { return __builtin_bit_cast(s16x4, __builtin_amdgcn_ds_read_tr16_b64_v4i16((LAS v4i16_t*)p)); }

__device__ __forceinline__ void attn_task(const Frame& F, int b, int hd, int qt, LAS unsigned char* vlds) {
    const int lane = F.lane, r32 = lane & 31, hi = lane >> 5;
    const size_t rowbase = (size_t)b * SEQ;
    const int q0 = qt * 32;
    bf16x8 qf[4];
    { const bf16_t* qp = F_PQ(F) + (rowbase + q0 + r32) * SBW + hd * HD + 8 * hi;
#pragma unroll
      for (int ks = 0; ks < 4; ++ks) qf[ks] = *(const bf16x8*)(qp + 16 * ks); }
    f32x16 o0, o1;
#pragma unroll
    for (int r = 0; r < 16; ++r) { o0[r] = 0.f; o1[r] = 0.f; }
    float carry = 0.f;
    const int pik = 16 * ((r32 >> 2) & 1) + (r32 & 3) + 4 * (r32 >> 3);
    const int i16 = lane & 15, tq = i16 >> 2, tp = i16 & 3;
    const LAS unsigned char* vrd = vlds + (16 * hi + tq) * 128 + (16 * ((lane >> 4) & 1) + 4 * tp) * 2;
    for (int jt = qt; jt >= 0; --jt) {
        const int key0 = jt * 32;
        bf16x8 kf[4];
        { const bf16_t* kp = F_PK(F) + (rowbase + key0 + pik) * SBW + hd * HD + 8 * hi;
#pragma unroll
          for (int ks = 0; ks < 4; ++ks) kf[ks] = *(const bf16x8*)(kp + 16 * ks); }
        u32x4 vv[4];
#pragma unroll
        for (int i = 0; i < 4; ++i) { const int p = lane + 64 * i, row = p >> 3, ch = p & 7; vv[i] = *(const u32x4*)(F_PV(F) + (rowbase + key0 + row) * SBW + hd * HD + ch * 8); }
        asm volatile("" ::: "memory");
#pragma unroll
        for (int i = 0; i < 4; ++i) { const int p = lane + 64 * i, row = p >> 3, ch = p & 7; *(LAS u32x4*)(vlds + row * 128 + ch * 16) = vv[i]; }
        f32x16 s;
#pragma unroll
        for (int r = 0; r < 16; ++r) s[r] = 0.f;
#pragma unroll
        for (int ks = 0; ks < 4; ++ks) s = mfma32(kf[ks], qf[ks], s);
        const bool diag = (jt == qt);
        float lf[16];
#pragma unroll
        for (int r = 0; r < 16; ++r) {
            const float z = s[r];
            const float sp = __builtin_fmaxf(z, 0.f) + __builtin_amdgcn_logf(1.0f + __builtin_amdgcn_exp2f(-__builtin_fabsf(z)));
            const bool valid = !diag || (16 * hi + r < r32);
            lf[r] = valid ? -sp : 0.f;
        }
        float run = 0.f;
#pragma unroll
        for (int r = 15; r >= 0; --r) { run += lf[r]; lf[r] = run; }
        const float tot_other = __shfl_xor(run, 32);
        const float off = carry + (hi == 0 ? tot_other : 0.f);
        float a[16];
#pragma unroll
        for (int r = 0; r < 16; ++r) {
            const bool valid = !diag || (16 * hi + r < r32);
            const float e = __builtin_amdgcn_exp2f(s[r] + lf[r] + off);
            a[r] = valid ? e : 0.f;
        }
        carry += run + tot_other;
        bf16x8 pf0, pf1;
        { u32x4 w0, w1;
          w0.x = cvtpk(a[0], a[1]); w0.y = cvtpk(a[2], a[3]); w0.z = cvtpk(a[4], a[5]); w0.w = cvtpk(a[6], a[7]);
          w1.x = cvtpk(a[8], a[9]); w1.y = cvtpk(a[10], a[11]); w1.z = cvtpk(a[12], a[13]); w1.w = cvtpk(a[14], a[15]);
          pf0 = __builtin_bit_cast(bf16x8, w0); pf1 = __builtin_bit_cast(bf16x8, w1); }
        asm volatile("s_waitcnt lgkmcnt(0)" ::: "memory");
#pragma unroll
        for (int dh = 0; dh < 2; ++dh) {
            const s16x4 l0 = vtr(vrd + dh * 64), h0 = vtr(vrd + 4 * 128 + dh * 64), l1 = vtr(vrd + 8 * 128 + dh * 64), h1 = vtr(vrd + 12 * 128 + dh * 64);
            const bf16x8 vf0 = __builtin_shufflevector(l0, h0, 0, 1, 2, 3, 4, 5, 6, 7), vf1 = __builtin_shufflevector(l1, h1, 0, 1, 2, 3, 4, 5, 6, 7);
            if (dh == 0) { o0 = mfma32(pf0, vf0, o0); o0 = mfma32(pf1, vf1, o0); } else { o1 = mfma32(pf0, vf0, o1); o1 = mfma32(pf1, vf1, o1); }
        }
        asm volatile("s_waitcnt lgkmcnt(0)" ::: "memory");
        if (__all(carry <= -151.0f)) break;
    }
    bf16_t* op = F_MIXIN(F) + (rowbase + q0) * DM + PW + hd * HD + r32;
#pragma unroll
    for (int r = 0; r < 16; ++r) { const int qr = (r & 3) + 8 * (r >> 2) + 4 * hi;
        op[(size_t)qr * DM] = (bf16_t)(cvtpk(o0[r], 0.f) & 0xffffu); op[(size_t)qr * DM + 32] = (bf16_t)(cvtpk(o1[r], 0.f) & 0xffffu); }
}

__device__ __forceinline__ void ph_mix(const Frame& F, int l) {
    const int gw = blockIdx.x * NWAVES + F.wave, NGW = F.G * NWAVES;
    LAS unsigned char* vlds = F.lds + RING_OFF + F.wave * 4096;
    constexpr int NTASK = NB * NH * (SEQ / 32);
    for (int task = gw; task < NTASK; task += NGW) { const int qt = task % (SEQ / 32), bh = task / (SEQ / 32); attn_task(F, bh / NH, bh % NH, qt, vlds); }
    for (size_t it = (size_t)blockIdx.x * 512 + F.tid; it < (size_t)T * 64; it += (size_t)F.G * 512) {
        const int t = (int)(it >> 6), ch = (int)(it & 63), g = ch >> 4, w = 2 << g, pos = t & (SEQ - 1), n = (pos + 1 < w) ? pos + 1 : w;
        const bf16_t* up = F_PU(F) + (size_t)t * PW + ch * 8;
        float acc[8];
#pragma unroll
        for (int j = 0; j < 8; ++j) acc[j] = 0.f;
        u32x4 own = *(const u32x4*)up;
        for (int i = 0; i < n; ++i) { const u32x4 v = *(const u32x4*)(up - (size_t)i * PW);
            acc[0] += bflo(v.x); acc[1] += bfhi(v.x); acc[2] += bflo(v.y); acc[3] += bfhi(v.y); acc[4] += bflo(v.z); acc[5] += bfhi(v.z); acc[6] += bflo(v.w); acc[7] += bfhi(v.w); }
        const float inv = 1.0f / (float)n;
        u32x4 o; o.x = cvtpk(acc[0] * inv - bflo(own.x), acc[1] * inv - bfhi(own.x)); o.y = cvtpk(acc[2] * inv - bflo(own.y), acc[3] * inv - bfhi(own.y));
        o.z = cvtpk(acc[4] * inv - bflo(own.z), acc[5] * inv - bfhi(own.z)); o.w = cvtpk(acc[6] * inv - bflo(own.w), acc[7] * inv - bfhi(own.w));
        *(u32x4*)(F_MIXIN(F) + (size_t)t * DM + ch * 8) = o;
    }
}

__device__ __forceinline__ void ph_ln1r(const Frame& F, const Args& A, int l) {
    const int lane = F.lane;
    const int gw = blockIdx.x * NWAVES + F.wave, NGW = F.G * NWAVES;
    const float* lg_ = A.in[5] + (size_t)l * DM; const float* lb_ = A.in[6] + (size_t)l * DM;
    const float* brg = A.in[8] + l * NG; const float* bre = A.in[10] + l * NE;
    f32x4 gg[4], bb[4];
#pragma unroll
    for (int j = 0; j < 4; ++j) { gg[j] = *((const f32x4*)lg_ + lane + 64 * j); bb[j] = *((const f32x4*)lb_ + lane + 64 * j); }
    unsigned* cur = F_CTL(F) + CW_CUR + l * 64;
    for (int t = gw; t < T; t += NGW) {
        u32x2* hp = (u32x2*)(F_HB(F) + (size_t)t * DM) + lane;
        const f32x4* mp = (const f32x4*)(F_MIX(F) + (size_t)t * DM) + lane;
        f32x4 v[4]; float s = 0.f;
#pragma unroll
        for (int j = 0; j < 4; ++j) { const u32x2 hw = hp[64 * j]; const f32x4 m = mp[64 * j];
            v[j].x = ALPHA * bflo(hw.x) + m.x; v[j].y = ALPHA * bfhi(hw.x) + m.y; v[j].z = ALPHA * bflo(hw.y) + m.z; v[j].w = ALPHA * bfhi(hw.y) + m.w;
            s += (v[j].x + v[j].y) + (v[j].z + v[j].w); }
        const float mean = wave_sum(s) * (1.0f / DM); float s2 = 0.f;
#pragma unroll
        for (int j = 0; j < 4; ++j) { v[j] = v[j] - mean; s2 += (v[j].x * v[j].x + v[j].y * v[j].y) + (v[j].z * v[j].z + v[j].w * v[j].w); }
        const float rstd = 1.0f / sqrtf(wave_sum(s2) * (1.0f / DM) + LN_EPS);
#pragma unroll
        for (int j = 0; j < 4; ++j) { v[j] = v[j] * rstd * gg[j] + bb[j]; u32x2 o; o.x = cvtpk(v[j].x, v[j].y); o.y = cvtpk(v[j].z, v[j].w); hp[64 * j] = o; }
        float gl[NG];
#pragma unroll
        for (int n = 0; n < NG; ++n) { const f32x4* wr = (const f32x4*)(F_WRT(F) + (size_t)n * DM) + lane; float p = 0.f;
#pragma unroll
            for (int j = 0; j < 4; ++j) { const f32x4 w = wr[64 * j]; p += (v[j].x * w.x + v[j].y * w.y) + (v[j].z * w.z + v[j].w * w.w); }
            gl[n] = wave_sum(p) + brg[n]; }
        int gi = 0; float gm = gl[0];
#pragma unroll
        for (int i = 1; i < NG; ++i) if (gl[i] > gm) { gm = gl[i]; gi = i; }
        gi = __builtin_amdgcn_readfirstlane(gi);
        float gs = 0.f;
#pragma unroll
        for (int i = 0; i < NG; ++i) gs += __expf(gl[i] - gm);
        const float gp = 1.0f / gs;
        int i1 = 0, i2 = 0; float m1 = -INFINITY, m2 = -INFINITY;
#pragma unroll 1
        for (int jj = 0; jj < EPG; ++jj) { const f32x4* wr = (const f32x4*)(F_WRT(F) + (size_t)(NG + gi * EPG + jj) * DM) + lane; float p = 0.f;
#pragma unroll
            for (int j = 0; j < 4; ++j) { const f32x4 w = wr[64 * j]; p += (v[j].x * w.x + v[j].y * w.y) + (v[j].z * w.z + v[j].w * w.w); }
            const float x = wave_sum(p) + bre[gi * EPG + jj];
            if (x > m1) { m2 = m1; i2 = i1; m1 = x; i1 = jj; } else if (x > m2) { m2 = x; i2 = jj; } }
        const float ex = __expf(m2 - m1), pa = 1.0f / (1.0f + ex), pb = ex * pa;
        if (lane == 0) {
            const int e0 = gi * EPG + i1, e1 = gi * EPG + i2;
            const int p0 = (int)__hip_atomic_fetch_add(cur + e0, 1u, __ATOMIC_RELAXED, __HIP_MEMORY_SCOPE_AGENT);
            const int p1 = (int)__hip_atomic_fetch_add(cur + e1, 1u, __ATOMIC_RELAXED, __HIP_MEMORY_SCOPE_AGENT);
            F_TOKE(F)[2 * t] = e0; F_TOKE(F)[2 * t + 1] = e1; F_TOKP(F)[2 * t] = p0; F_TOKP(F)[2 * t + 1] = p1;
            F_SLOTT(F)[(size_t)e0 * CAP + p0] = t; F_SLOTT(F)[(size_t)e1 * CAP + p1] = t;
            F_SLOTW(F)[(size_t)e0 * CAP + p0] = gp * pa; F_SLOTW(F)[(size_t)e1 * CAP + p1] = gp * pb;
        }
    }
}

__device__ __forceinline__ int build_table(const Frame& F, int l) {
    LAS int* tbl = (LAS int*)(F.lds + TBL_OFF);
    if (F.tid < 64) {
        const int c = (F.tid < NE) ? (int)__hip_atomic_load(F_CTL(F) + CW_CUR + l * 64 + F.tid, __ATOMIC_RELAXED, __HIP_MEMORY_SCOPE_AGENT) : 0;
        const int nt = (c + 255) >> 8;
        int inc = nt;
#pragma unroll
        for (int o = 1; o < 64; o <<= 1) { const int y = __shfl_up(inc, o); if (F.tid >= o) inc += y; }
        if (F.tid < NE) { tbl[F.tid] = inc - nt; tbl[64 + F.tid] = c; }
        if (F.tid == NE - 1) tbl[NE] = inc;
    }
    __syncthreads();
    return tbl[NE];
}

__device__ __forceinline__ void ph_gather(const Frame& F, int l) {
    const int ntile = build_table(F, l);
    const LAS int* tbl = (const LAS int*)(F.lds + TBL_OFF);
    const int gw = blockIdx.x * NWAVES + F.wave, NGW = F.G * NWAVES, lane = F.lane;
    for (int R = gw; R < ntile * 256; R += NGW) {
        const int pm = R >> 8, r = R & 255;
        int e = 0;
#pragma unroll 1
        for (int j = 1; j < NE; ++j) e += (tbl[j] <= pm) ? 1 : 0;
        const int idx = (pm - tbl[e]) * 256 + r;
        const int tok = idx < tbl[64 + e] ? F_SLOTT(F)[(size_t)e * CAP + idx] : 0;
        const u32x4* src = (const u32x4*)(F_HB(F) + (size_t)tok * DM); u32x4* dst = (u32x4*)(F_XS(F) + (size_t)R * DM);
        dst[lane] = src[lane]; dst[lane + 64] = src[lane + 64];
    }
}

__device__ __forceinline__ void ph_comb(const Frame& F, const Args& A, int l) {
    (void)build_table(F, l);
    const LAS int* tbl = (const LAS int*)(F.lds + TBL_OFF);
    const int lane = F.lane;
    const int gw = blockIdx.x * NWAVES + F.wave, NGW = F.G * NWAVES;
    const float* lg_ = A.in[14] + (size_t)l * DM; const float* lb_ = A.in[15] + (size_t)l * DM;
    f32x4 gg[4], bb[4];
#pragma unroll
    for (int j = 0; j < 4; ++j) { gg[j] = *((const f32x4*)lg_ + lane + 64 * j); bb[j] = *((const f32x4*)lb_ + lane + 64 * j); }
    for (int t = gw; t < T; t += NGW) {
        const int e0 = F_TOKE(F)[2 * t], e1 = F_TOKE(F)[2 * t + 1];
        const size_t s0 = (size_t)tbl[e0] * 256 + F_TOKP(F)[2 * t], s1 = (size_t)tbl[e1] * 256 + F_TOKP(F)[2 * t + 1];
        u32x2* hp = (u32x2*)(F_HB(F) + (size_t)t * DM) + lane;
        const u32x2* y0 = (const u32x2*)(F_Y(F) + s0 * DM) + lane; const u32x2* y1 = (const u32x2*)(F_Y(F) + s1 * DM) + lane;
        f32x4 v[4]; float s = 0.f;
#pragma unroll
        for (int j = 0; j < 4; ++j) { const u32x2 hw = hp[64 * j], a = y0[64 * j], b = y1[64 * j];
            v[j].x = ALPHA * bflo(hw.x) + (bflo(a.x) + bflo(b.x)); v[j].y = ALPHA * bfhi(hw.x) + (bfhi(a.x) + bfhi(b.x));
            v[j].z = ALPHA * bflo(hw.y) + (bflo(a.y) + bflo(b.y)); v[j].w = ALPHA * bfhi(hw.y) + (bfhi(a.y) + bfhi(b.y));
            s += (v[j].x + v[j].y) + (v[j].z + v[j].w); }
        const float mean = wave_sum(s) * (1.0f / DM); float s2 = 0.f;
#pragma unroll
        for (int j = 0; j < 4; ++j) { v[j] = v[j] - mean; s2 += (v[j].x * v[j].x + v[j].y * v[j].y) + (v[j].z * v[j].z + v[j].w * v[j].w); }
        const float rstd = 1.0f / sqrtf(wave_sum(s2) * (1.0f / DM) + LN_EPS);
#pragma unroll
        for (int j = 0; j < 4; ++j) { v[j] = v[j] * rstd * gg[j] + bb[j]; u32x2 o; o.x = cvtpk(v[j].x, v[j].y); o.y = cvtpk(v[j].z, v[j].w); hp[64 * j] = o; }
        if (l == DEPTH - 1) { f32x4* op = (f32x4*)(A.out + (size_t)t * DM) + lane;
#pragma unroll
            for (int j = 0; j < 4; ++j) op[64 * j] = v[j]; }
    }
}

constexpr int NPH = 9;

__global__ void __launch_bounds__(NWAVES * 64, 2) fwd_kernel(Args args) {
    extern __shared__ __attribute__((aligned(16))) unsigned char lds_raw[];
    Frame F;
    F.lds = (LAS unsigned char*)lds_raw;
    F.G = gridDim.x;
    F.ws = args.ws;

    for (int p = args.ph_lo; p < args.ph_hi; ++p) {
        const int l = p / NPH;
        { int tid_ = threadIdx.x; asm volatile("" : "+v"(tid_)); F.tid = tid_; F.lane = tid_ & 63; F.wave = __builtin_amdgcn_readfirstlane(tid_ >> 6); }
#ifdef ONLY_PHASE
        const int k = ONLY_PHASE;
#else
        const int k = p % NPH;
#endif
        if (k == 0) { ph_conv(F, args, l); }
        else if (k == 1) {
            pg8::Gemm g{F_HB(F), F_WIN(F), DM}; pg8::DenseOrder S; S.init(T, PROJ, DM, F.G, (int)blockIdx.x);
            pg8::EpiBf16 E{F_PU(F), 512, 512, (size_t)T * 512};
            pg8::gemm_phase<pg8::EpiBf16, pg8::DenseOrder, true, true>(F.lds + RING_OFF, g, S, E, F.tid);
        }
        else if (k == 2) { ph_mix(F, l); }
        else if (k == 3) {
            pg8::Gemm g{F_MIXIN(F), F_WO(F), DM}; pg8::DenseOrder S; S.init(T, DM, DM, F.G, (int)blockIdx.x);
            pg8::EpiF32 E{F_MIX(F), DM};
            pg8::gemm_phase<pg8::EpiF32, pg8::DenseOrder, true, true>(F.lds + RING_OFF, g, S, E, F.tid);
        }
        else if (k == 4) { ph_ln1r(F, args, l); }
        else if (k == 5) { ph_gather(F, l); }
        else if (k == 6) {
            const int ntile = build_table(F, l);
            pg8::Gemm g{F_XS(F), F_WGU(F), DM}; pg8::GroupedOrder S; S.init(ntile, 1024, DM, F.G, (int)blockIdx.x, (const LAS int*)(F.lds + TBL_OFF), CAP);
            pg8::EpiSwiGLU E{F_HID(F), DE};
            pg8::gemm_phase<pg8::EpiSwiGLU, pg8::GroupedOrder, true, true>(F.lds + RING_OFF, g, S, E, F.tid);
        }
        else if (k == 7) {
            const int ntile = build_table(F, l);
            pg8::Gemm g{F_HID(F), F_WD(F), DE}; pg8::GroupedOrder S; S.init(ntile, 1024, DE, F.G, (int)blockIdx.x, (const LAS int*)(F.lds + TBL_OFF), CAP);
            pg8::EpiRowScaleBf16 E{F_Y(F), DM, F_SLOTW(F)};
            pg8::gemm_phase<pg8::EpiRowScaleBf16, pg8::GroupedOrder, true, true>(F.lds + RING_OFF, g, S, E, F.tid);
        }
        else { ph_comb(F, args, l); }
        __syncthreads();
    }
}

extern "C" void kernel_launch(void* const* d_in, const int* in_sizes, int n_in, void* d_out, int out_size, void* d_ws, size_t ws_size, hipStream_t stream) {
    static int grid = 0;
    if (grid == 0) {
        if (n_in != 16 || out_size != T * DM || ws_size < WS_END) { fprintf(stderr, "kernel_launch: unexpected shapes / workspace (n_in %d, out %d, ws %zu)\n", n_in, out_size, ws_size); grid = -1; return; }
        int dev = 0, cus = 0;
        if (hipGetDevice(&dev) != hipSuccess || hipDeviceGetAttribute(&cus, hipDeviceAttributeMultiprocessorCount, dev) != hipSuccess) { grid = -1; return; }
        if (hipFuncSetAttribute((const void*)fwd_kernel, hipFuncAttributeMaxDynamicSharedMemorySize, LDS_BYTES) != hipSuccess) { fprintf(stderr, "kernel_launch: hipFuncSetAttribute failed\n"); grid = -1; return; }
        (void)hipGetLastError();
        grid = cus;
    }
    if (grid < 0) return;
    (void)hipMemsetAsync((char*)d_ws + WS_CTL, 0, CTL_ZERO_BYTES, stream);
    Args a{};
    for (int i = 0; i < 16; ++i) a.in[i] = (const float*)d_in[i];
    a.out = (float*)d_out; a.ws = (unsigned char*)d_ws;
    for (int p = 0; p < DEPTH * NPH; ++p) {
        a.ph_lo = p; a.ph_hi = p + 1;
        hipLaunchKernelGGL(fwd_kernel, dim3(grid), dim3(NWAVES * 64), LDS_BYTES, stream, a);
    }
}
```
